# Optimizing an MI355X kernel written in HIP

```python
import jax, jax.numpy as jnp
from jax import lax
import numpy as np

D_MODEL = 1024
BATCH = 2
SEQ = 8192
DEPTH = 1

A_HEADS = 4
A_DK = 128
A_DV = 128
A_QK = A_HEADS * A_DK
A_WIDTH = A_HEADS * A_DV
CHUNK = 64
B_HEADS = 8
B_KV_HEADS = 2
B_HEAD_DIM = 64
B_GROUP = B_HEADS // B_KV_HEADS
B_WIDTH = B_HEADS * B_HEAD_DIM
B_KV = B_KV_HEADS * B_HEAD_DIM
WINDOW = 128
BLOCK = 128
MIX_WIDTH = A_WIDTH + B_WIDTH
D_FF = -(-8 * D_MODEL // (3 * 256)) * 256
EPS = 1e-6
IN_SIZES = (A_QK, A_QK, A_WIDTH, A_WIDTH, B_WIDTH, B_KV, B_KV)
IN_COLS = sum(IN_SIZES)
SPLITS = tuple(int(s) for s in np.cumsum(IN_SIZES)[:-1])

kernel_name = 'hymba_hgrn2_swa_sink_alibi_block'


def rmsnorm(x, g):
    xf = x.astype(jnp.float32)
    y = xf * lax.rsqrt(jnp.mean(xf * xf, axis=-1, keepdims=True) + EPS)
    return (y * g.astype(jnp.float32)).astype(x.dtype)


def hgrn2_mixer(q, f_logit, i, g, lb, norm_g):
    bsz, s, _ = q.shape
    n = s // CHUNK
    f32 = jnp.float32
    qf = jax.nn.silu(q.astype(f32))
    forget = lb + (1.0 - lb) * jax.nn.sigmoid(f_logit.astype(f32))
    key = 1.0 - forget
    log_f = jnp.log(forget)

    def chunks(t, d):
        return t.reshape(bsz, n, CHUNK, A_HEADS, d).transpose(0, 3, 1, 2, 4)

    q_c = chunks(qf, A_DK)
    k_c = chunks(key, A_DK)
    v_c = chunks(i.astype(f32), A_DV)
    b = jnp.cumsum(chunks(log_f, A_DK), axis=3)
    b_last = b[:, :, :, -1:, :]
    q_dec = q_c * jnp.exp(b)
    k_intra = k_c * jnp.exp(-b)
    k_state = k_c * jnp.exp(b_last - b)
    causal = jnp.tril(jnp.ones((CHUNK, CHUNK), dtype=bool))
    a = jnp.where(causal, jnp.einsum('bhnck,bhnsk->bhncs', q_dec, k_intra), 0.0)
    o_intra = jnp.einsum('bhncs,bhnsv->bhncv', a, v_c)
    upd = jnp.einsum('bhnsk,bhnsv->bhnkv', k_state, v_c)
    decay = jnp.exp(b_last[:, :, :, 0, :])

    def step(state, inp):
        dec, u = inp
        return dec[..., None] * state + u, state

    s0 = jnp.zeros((bsz, A_HEADS, A_DK, A_DV), f32)
    _, s_prev = lax.scan(step, s0, (jnp.moveaxis(decay, 2, 0), jnp.moveaxis(upd, 2, 0)))
    s_prev = jnp.moveaxis(s_prev, 0, 2)
    o = o_intra + jnp.einsum('bhnck,bhnkv->bhncv', q_dec, s_prev)
    o = o.transpose(0, 2, 3, 1, 4).reshape(bsz, s, A_HEADS, A_DV)
    o = o * lax.rsqrt(jnp.mean(o * o, axis=-1, keepdims=True) + EPS)
    o = o.reshape(bsz, s, A_WIDTH) * norm_g.astype(f32) * jax.nn.silu(g.astype(f32))
    return o.astype(q.dtype)


def alibi_slopes():
    return jnp.exp2(-(8.0 / B_HEADS) * jnp.arange(1, B_HEADS + 1, dtype=jnp.float32))


def swa_sink_attention(q, k, v, sinks, norm_g):
    bsz, s, _ = q.shape
    nb = s // BLOCK
    f32 = jnp.float32
    qb = q.reshape(bsz, nb, BLOCK, B_KV_HEADS, B_GROUP, B_HEAD_DIM)
    kb = k.reshape(bsz, nb, BLOCK, B_KV_HEADS, B_HEAD_DIM)
    vb = v.reshape(bsz, nb, BLOCK, B_KV_HEADS, B_HEAD_DIM)

    def with_prev(t):
        prev = jnp.pad(t, ((0, 0), (1, 0), (0, 0), (0, 0), (0, 0)))[:, :-1]
        return jnp.concatenate([prev, t], axis=2)

    kk = with_prev(kb)
    vv = with_prev(vb)
    scores = jnp.einsum('bnqhgd,bnshd->bnhgqs', qb, kk).astype(f32) * (B_HEAD_DIM ** -0.5)
    qi = jnp.arange(BLOCK)[:, None]
    kj = jnp.arange(2 * BLOCK)[None, :]
    dist = qi + BLOCK - kj
    key_pos = jnp.arange(nb)[:, None] * BLOCK - BLOCK + kj
    valid = ((dist >= 0) & (dist < WINDOW))[None] & (key_pos >= 0)[:, None, :]
    slopes = alibi_slopes().reshape(B_KV_HEADS, B_GROUP)
    scores = scores - slopes[:, :, None, None] * dist.astype(f32)
    scores = jnp.where(valid[None, :, None, None], scores, -jnp.inf)
    sink = sinks.astype(f32).reshape(B_KV_HEADS, B_GROUP)[None, None, :, :, None, None]
    m = jnp.maximum(jnp.max(scores, axis=-1, keepdims=True), sink)
    p = jnp.exp(scores - m)
    p = p / (jnp.sum(p, axis=-1, keepdims=True) + jnp.exp(sink - m))
    o = jnp.einsum('bnhgqs,bnshd->bnqhgd', p, vv.astype(f32))
    o = o.reshape(bsz, s, B_WIDTH)
    return rmsnorm(o, norm_g).astype(q.dtype)


def setup_inputs(seed: int = 0) -> dict:
    key = jax.random.key(seed)
    ks = jax.random.split(key, 13)
    f32 = jnp.float32
    nrm = lambda k, shape, scale: jax.random.normal(k, shape, f32) * scale
    return {
        'x': jax.random.normal(ks[0], (BATCH, SEQ, D_MODEL), f32),
        'ln1_g': 1.0 + nrm(ks[1], (DEPTH, D_MODEL), 0.02),
        'w_in': nrm(ks[2], (DEPTH, D_MODEL, IN_COLS), D_MODEL ** -0.5),
        'lb_logits': nrm(ks[3], (DEPTH + 1, A_QK), 0.1),
        'hgrn_norm_g': 1.0 + nrm(ks[4], (DEPTH, A_WIDTH), 0.02),
        'attn_sinks': nrm(ks[5], (DEPTH, B_HEADS), 0.5),
        'attn_norm_g': 1.0 + nrm(ks[6], (DEPTH, B_WIDTH), 0.02),
        'w_out': nrm(ks[7], (DEPTH, MIX_WIDTH, D_MODEL), MIX_WIDTH ** -0.5),
        'ln2_g': 1.0 + nrm(ks[8], (DEPTH, D_MODEL), 0.02),
        'w_gate': nrm(ks[9], (DEPTH, D_MODEL, D_FF), D_MODEL ** -0.5),
        'w_up': nrm(ks[10], (DEPTH, D_MODEL, D_FF), D_MODEL ** -0.5),
        'w_down': nrm(ks[11], (DEPTH, D_FF, D_MODEL), D_FF ** -0.5),
        'final_g': 1.0 + nrm(ks[12], (D_MODEL,), 0.02),
    }


def reference(x, ln1_g, w_in, lb_logits, hgrn_norm_g, attn_sinks, attn_norm_g, w_out, ln2_g, w_gate, w_up, w_down, final_g):
    lower_bounds = jnp.cumsum(jax.nn.softmax(lb_logits.astype(jnp.float32), axis=0), axis=0)
    h = x
    for l in range(DEPTH):
        u = rmsnorm(h, ln1_g[l])
        proj = u @ w_in[l]
        a_q, a_f, a_i, a_g, b_q, b_k, b_v = jnp.split(proj, SPLITS, axis=-1)
        y_a = hgrn2_mixer(a_q, a_f, a_i, a_g, lower_bounds[l], hgrn_norm_g[l])
        y_b = swa_sink_attention(b_q, b_k, b_v, attn_sinks[l], attn_norm_g[l])
        h = h + jnp.concatenate([y_a, y_b], axis=-1) @ w_out[l]
        u = rmsnorm(h, ln2_g[l])
        h = h + (jax.nn.silu(u @ w_gate[l]) * (u @ w_up[l])) @ w_down[l]
    return rmsnorm(h, final_g)
```

```cpp
#include <hip/hip_runtime.h>
#include <cstdint>
#include <cstdio>

namespace v0 {
constexpr int D = 1024, BATCH = 2, SEQ = 8192, M = BATCH * SEQ;
constexpr int AH = 4, ADK = 128, ADV = 128, AQK = 512, AW = 512;
constexpr int BHEADS = 8, BKVH = 2, BHD = 64, BW = 512, BKV = 128, WINDOW = 128;
constexpr int MIXW = 1024, DFF = 2816, INC = 2816;
constexpr float EPS = 1e-6f;
constexpr int C_AQ = 0, C_AF = 512, C_AI = 1024, C_AG = 1536, C_BQ = 2048, C_BK = 2560, C_BV = 2688;

__device__ __forceinline__ float wave_sum(float v) {
#pragma unroll
    for (int o = 1; o < 64; o <<= 1) v += __shfl_xor(v, o);
    return v;
}
__device__ __forceinline__ float sigmoidf_(float z) { return 1.0f / (1.0f + expf(-z)); }
__device__ __forceinline__ float siluf_(float z) { return z / (1.0f + expf(-z)); }

__global__ __launch_bounds__(256) void rmsnorm_rows(const float* x, const float* g, float* out, int rows) {
    const int wave = (blockIdx.x * 256 + threadIdx.x) >> 6, lane = threadIdx.x & 63;
    if (wave >= rows) return;
    const float4* xr = (const float4*)(x + (size_t)wave * D);
    float4 v[4]; float s = 0.f;
#pragma unroll
    for (int j = 0; j < 4; ++j) { v[j] = xr[lane + 64 * j]; s += v[j].x * v[j].x + v[j].y * v[j].y + v[j].z * v[j].z + v[j].w * v[j].w; }
    s = wave_sum(s);
    const float r = rsqrtf(s * (1.0f / D) + EPS);
    float4* o = (float4*)(out + (size_t)wave * D);
#pragma unroll
    for (int j = 0; j < 4; ++j) { const float4 gg = ((const float4*)g)[lane + 64 * j]; float4 w; w.x = v[j].x * r * gg.x; w.y = v[j].y * r * gg.y; w.z = v[j].z * r * gg.z; w.w = v[j].w * r * gg.w; o[lane + 64 * j] = w; }
}

template <int MODE>
__global__ __launch_bounds__(256) void gemm_f32(const float* __restrict__ A, int lda, const float* __restrict__ B, const float* __restrict__ B2, int ldb,
                                               float* C, int ldc, const float* R, int Kdim) {
    __shared__ float As[16][132];
    __shared__ float Bs[16][132];
    __shared__ float Bs2[MODE == 2 ? 16 : 1][132];
    const int bm = blockIdx.y * 128, bn = blockIdx.x * 128;
    const int tid = threadIdx.x, tx = tid & 15, ty = tid >> 4;
    float acc[8][8], acc2[MODE == 2 ? 8 : 1][8];
#pragma unroll
    for (int i = 0; i < 8; ++i)
#pragma unroll
        for (int j = 0; j < 8; ++j) { acc[i][j] = 0.f; if (MODE == 2) acc2[i][j] = 0.f; }
    for (int k0 = 0; k0 < Kdim; k0 += 16) {
#pragma unroll
        for (int i = 0; i < 2; ++i) {
            const int idx = tid + i * 256, r = idx >> 2, c4 = idx & 3;
            const float4 v = *(const float4*)&A[(size_t)(bm + r) * lda + k0 + c4 * 4];
            As[c4 * 4 + 0][r] = v.x; As[c4 * 4 + 1][r] = v.y; As[c4 * 4 + 2][r] = v.z; As[c4 * 4 + 3][r] = v.w;
            const int rb = idx >> 5, cb = idx & 31;
            *(float4*)&Bs[rb][cb * 4] = *(const float4*)&B[(size_t)(k0 + rb) * ldb + bn + cb * 4];
            if (MODE == 2) *(float4*)&Bs2[rb][cb * 4] = *(const float4*)&B2[(size_t)(k0 + rb) * ldb + bn + cb * 4];
        }
        __syncthreads();
#pragma unroll
        for (int k = 0; k < 16; ++k) {
            float a[8], b[8], b2[8];
            *(float4*)&a[0] = *(const float4*)&As[k][ty * 8]; *(float4*)&a[4] = *(const float4*)&As[k][ty * 8 + 4];
            *(float4*)&b[0] = *(const float4*)&Bs[k][tx * 8]; *(float4*)&b[4] = *(const float4*)&Bs[k][tx * 8 + 4];
            if (MODE == 2) { *(float4*)&b2[0] = *(const float4*)&Bs2[k][tx * 8]; *(float4*)&b2[4] = *(const float4*)&Bs2[k][tx * 8 + 4]; }
#pragma unroll
            for (int i = 0; i < 8; ++i)
#pragma unroll
                for (int j = 0; j < 8; ++j) { acc[i][j] = fmaf(a[i], b[j], acc[i][j]); if (MODE == 2) acc2[i][j] = fmaf(a[i], b2[j], acc2[i][j]); }
        }
        __syncthreads();
    }
#pragma unroll
    for (int i = 0; i < 8; ++i) {
        const size_t off = (size_t)(bm + ty * 8 + i) * ldc + bn + tx * 8;
#pragma unroll
        for (int j = 0; j < 8; ++j) {
            float v = acc[i][j];
            if (MODE == 1) v += R[off + j];
            if (MODE == 2) v = siluf_(v) * acc2[i][j];
            C[off + j] = v;
        }
    }
}

__global__ void lb_kernel(const float* lbl, float* lb) {
    const int k = blockIdx.x * blockDim.x + threadIdx.x;
    if (k < AQK) { const float a = lbl[k], b = lbl[AQK + k], m = fmaxf(a, b); const float ea = expf(a - m), eb = expf(b - m); lb[k] = ea / (ea + eb); }
}

__global__ __launch_bounds__(128) void hgrn_naive(const float* proj, const float* lb, float* mix) {
    constexpr int T = 8;
    __shared__ float sq[T][128], sf[T][128], sk[T][128];
    const int b = blockIdx.x / AH, h = blockIdx.x % AH, tid = threadIdx.x;
    float S[128];
#pragma unroll
    for (int k = 0; k < 128; ++k) S[k] = 0.f;
    const float lbk = lb[h * 128 + tid];
    for (int t0 = 0; t0 < SEQ; t0 += T) {
        __syncthreads();
#pragma unroll
        for (int j = 0; j < T; ++j) {
            const float* pr = proj + (size_t)(b * SEQ + t0 + j) * INC;
            const float q = pr[C_AQ + h * 128 + tid], z = pr[C_AF + h * 128 + tid];
            const float f = lbk + (1.0f - lbk) * sigmoidf_(z);
            sq[j][tid] = siluf_(q); sf[j][tid] = f; sk[j][tid] = 1.0f - f;
        }
        __syncthreads();
#pragma unroll 1
        for (int j = 0; j < T; ++j) {
            const float* pr = proj + (size_t)(b * SEQ + t0 + j) * INC;
            const float vv = pr[C_AI + h * 128 + tid];
            float o = 0.f;
#pragma unroll
            for (int k = 0; k < 128; ++k) { S[k] = fmaf(sf[j][k], S[k], sk[j][k] * vv); o = fmaf(sq[j][k], S[k], o); }
            mix[(size_t)(b * SEQ + t0 + j) * MIXW + h * 128 + tid] = o;
        }
    }
}
__global__ __launch_bounds__(256) void hgrn_post(const float* proj, const float* norm_g, float* mix) {
    const int wave = (blockIdx.x * 256 + threadIdx.x) >> 6, lane = threadIdx.x & 63;
    const int tok = wave / AH, h = wave % AH;
    if (tok >= M) return;
    float* o = mix + (size_t)tok * MIXW + h * 128;
    const float a = o[lane], c = o[lane + 64];
    const float s = wave_sum(a * a + c * c);
    const float r = rsqrtf(s * (1.0f / 128.0f) + EPS);
    const float* g = proj + (size_t)tok * INC + C_AG + h * 128;
    o[lane] = a * r * norm_g[h * 128 + lane] * siluf_(g[lane]);
    o[lane + 64] = c * r * norm_g[h * 128 + lane + 64] * siluf_(g[lane + 64]);
}
__global__ __launch_bounds__(64) void swa_naive(const float* proj, const float* sinks, float* mix) {
    const int gid = blockIdx.x * 64 + threadIdx.x;
    const int t = gid % SEQ, head = (gid / SEQ) % BHEADS, b = gid / (SEQ * BHEADS);
    const int kvh = head / 4;
    const float slope = exp2f(-(float)(head + 1));
    float q[64];
    const float* qp = proj + (size_t)(b * SEQ + t) * INC + C_BQ + head * 64;
#pragma unroll
    for (int d = 0; d < 64; ++d) q[d] = qp[d];
    float m = sinks[head], l = 1.0f;
    float acc[64];
#pragma unroll
    for (int d = 0; d < 64; ++d) acc[d] = 0.f;
    const int s0 = t - (WINDOW - 1) < 0 ? 0 : t - (WINDOW - 1);
    for (int s = s0; s <= t; ++s) {
        const float* kp = proj + (size_t)(b * SEQ + s) * INC + C_BK + kvh * 64;
        const float* vp = proj + (size_t)(b * SEQ + s) * INC + C_BV + kvh * 64;
        float dot = 0.f;
#pragma unroll
        for (int d = 0; d < 64; ++d) dot = fmaf(q[d], kp[d], dot);
        const float sc = dot * 0.125f - slope * (float)(t - s);
        if (sc > m) { const float f = expf(m - sc); l *= f;
#pragma unroll
            for (int d = 0; d < 64; ++d) acc[d] *= f;
            m = sc; }
        const float p = expf(sc - m);
        l += p;
#pragma unroll
        for (int d = 0; d < 64; ++d) acc[d] = fmaf(p, vp[d], acc[d]);
    }
    const float il = 1.0f / l;
    float* op = mix + (size_t)(b * SEQ + t) * MIXW + 512 + head * 64;
#pragma unroll
    for (int d = 0; d < 64; ++d) op[d] = acc[d] * il;
}
__global__ __launch_bounds__(256) void attn_norm(const float* g, float* mix) {
    const int wave = (blockIdx.x * 256 + threadIdx.x) >> 6, lane = threadIdx.x & 63;
    if (wave >= M) return;
    float* o = mix + (size_t)wave * MIXW + 512;
    float v[8]; float s = 0.f;
#pragma unroll
    for (int j = 0; j < 8; ++j) { v[j] = o[lane + 64 * j]; s += v[j] * v[j]; }
    s = wave_sum(s);
    const float r = rsqrtf(s * (1.0f / 512.0f) + EPS);
#pragma unroll
    for (int j = 0; j < 8; ++j) o[lane + 64 * j] = v[j] * r * g[lane + 64 * j];
}

inline void forward(void* const* d_in, void* d_out, void* d_ws, hipStream_t st) {
    const float* x = (const float*)d_in[0]; const float* ln1 = (const float*)d_in[1]; const float* w_in = (const float*)d_in[2];
    const float* lbl = (const float*)d_in[3]; const float* hng = (const float*)d_in[4]; const float* sinks = (const float*)d_in[5];
    const float* ang = (const float*)d_in[6]; const float* w_out = (const float*)d_in[7]; const float* ln2 = (const float*)d_in[8];
    const float* w_gate = (const float*)d_in[9]; const float* w_up = (const float*)d_in[10]; const float* w_down = (const float*)d_in[11];
    const float* fing = (const float*)d_in[12];
    float* out = (float*)d_out; char* ws = (char*)d_ws;
    float* RA = (float*)ws;
    float* RB = (float*)(ws + (size_t)64 * 1048576);
    float* lb = (float*)(ws + (size_t)250 * 1048576);
    hipLaunchKernelGGL(lb_kernel, dim3(2), dim3(256), 0, st, lbl, lb);
    hipLaunchKernelGGL(rmsnorm_rows, dim3(M / 4), dim3(256), 0, st, x, ln1, RA, M);
    hipLaunchKernelGGL(gemm_f32<0>, dim3(INC / 128, M / 128), dim3(256), 0, st, RA, D, w_in, (const float*)nullptr, INC, RB, INC, (const float*)nullptr, D);
    hipLaunchKernelGGL(hgrn_naive, dim3(BATCH * AH), dim3(128), 0, st, RB, lb, RA);
    hipLaunchKernelGGL(hgrn_post, dim3(M * AH / 4), dim3(256), 0, st, RB, hng, RA);
    hipLaunchKernelGGL(swa_naive, dim3(M * BHEADS / 64), dim3(64), 0, st, RB, sinks, RA);
    hipLaunchKernelGGL(attn_norm, dim3(M / 4), dim3(256), 0, st, ang, RA);
    hipLaunchKernelGGL(gemm_f32<1>, dim3(D / 128, M / 128), dim3(256), 0, st, RA, MIXW, w_out, (const float*)nullptr, D, out, D, x, MIXW);
    hipLaunchKernelGGL(rmsnorm_rows, dim3(M / 4), dim3(256), 0, st, out, ln2, RA, M);
    hipLaunchKernelGGL(gemm_f32<2>, dim3(DFF / 128, M / 128), dim3(256), 0, st, RA, D, w_gate, w_up, DFF, RB, DFF, (const float*)nullptr, D);
    hipLaunchKernelGGL(gemm_f32<1>, dim3(D / 128, M / 128), dim3(256), 0, st, RB, DFF, w_down, (const float*)nullptr, D, out, D, out, DFF);
    hipLaunchKernelGGL(rmsnorm_rows, dim3(M / 4), dim3(256), 0, st, out, fing, out, M);
}
}

extern "C" void kernel_launch(void* const* d_in, const int* in_sizes, int n_in, void* d_out, int out_size, void* d_ws, size_t ws_size, hipStream_t stream) {
    v0::forward(d_in, d_out, d_ws, stream);
}
```

```cpp
#include <hip/hip_runtime.h>
#include <cstdio>
#include <cstdint>
#define HYBRID 0
namespace pg8 {
#define PG8_LAS __attribute__((address_space(3)))
typedef unsigned short bf16_t;
typedef short bf16x8 __attribute__((ext_vector_type(8)));
typedef float f32x4 __attribute__((ext_vector_type(4)));
typedef unsigned u32x4 __attribute__((ext_vector_type(4)));
constexpr int BM = 256, BK = 64, HALF = 128, HTB = HALF * BK * 2  , STAGE_BYTES = 8 * HTB, NXCD = 8, WGM = 8;

__host__ __device__ __forceinline__ int lds_byte(int r, int c) { const int st = (r >> 4) * 2 + (c >> 5), rr = r & 15, cc = c & 31, ob = rr * 64 + cc * 2; return st * 1024 + (ob ^ (((ob >> 9) & 1) << 5)); }
__host__ __device__ __forceinline__ void stage_rc(int b, int& R, int& C) { const int st = b / 1024, sb = b % 1024, swz = sb ^ (((sb >> 9) & 1) << 5); R = (st >> 1) * 16 + swz / 64; C = (st & 1) * 32 + (swz % 64) / 2; }
__host__ __device__ __forceinline__ int perm32(int rho) { const int n = rho >> 4, i = rho & 15; return 8 * (i >> 2) + 4 * n + (i & 3); }

struct Unit { int pm, pn; };
struct Gemm { const bf16_t* A; const bf16_t* Bt; int M, N, K; };

struct StaticOrder {
    int nM, nN, nwg, G, c;
    __host__ __device__ void init(int M, int N, int G_, int c_) { nM = M / BM; nN = N / BM; nwg = nM * nN; G = G_; c = c_; }
    __host__ __device__ bool next(int i, Unit& u) const {
        const long L = (long)i * G + c; if (L >= nwg) return false;
        int wgid = (int)L; { const int q = nwg / NXCD, r = nwg % NXCD, xcd = wgid % NXCD, off = wgid / NXCD; wgid = (xcd < r ? xcd * (q + 1) : r * (q + 1) + (xcd - r) * q) + off; }
        const int nig = WGM * nN, gid = wgid / nig, fm = gid * WGM, gsz = (nM - fm) < WGM ? (nM - fm) : WGM;
        u.pm = fm + ((wgid % nig) % gsz); u.pn = (wgid % nig) / gsz; return true;
    }
    __device__ __forceinline__ void a_ready(const Unit&) const {}
    __device__ __forceinline__ void done(const Unit&) const {}
};

typedef float f32x2c __attribute__((ext_vector_type(2))); typedef __bf16 bf16x2c __attribute__((ext_vector_type(2)));
__device__ __forceinline__ unsigned cvt_pk_bf16(float lo, float hi) { f32x2c v = {lo, hi}; bf16x2c b = __builtin_convertvector(v, bf16x2c); return __builtin_bit_cast(unsigned, b); }
typedef float f32x2 __attribute__((ext_vector_type(2)));
__device__ __forceinline__ float fast_sigmoid(float z) { return __builtin_amdgcn_rcpf(1.0f + __builtin_amdgcn_exp2f(-1.4426950408889634f * z)); }
__device__ __forceinline__ float fast_silu(float z) { return z * fast_sigmoid(z); }
__device__ __forceinline__ u32x4 pack8(const f32x4 a, const f32x4 b) { u32x4 w; w.x = cvt_pk_bf16(a[0], a[1]); w.y = cvt_pk_bf16(a[2], a[3]); w.z = cvt_pk_bf16(b[0], b[1]); w.w = cvt_pk_bf16(b[2], b[3]); return w; }

struct EpiInProj {
    static constexpr bool PERM = true, AFTER_DRAIN = false;
    bf16_t *AQ, *AV, *AG, *BQ, *BK, *BV; float* ALOGF; const float* lb; float qscale;
    __device__ __forceinline__ void operator()(const f32x4 (&acc)[2][2][4][2], const Unit& u, int wr, int wc, int fr, int fq) const {
        const int row0 = u.pm * BM + wr * 64 + fr, cw = wc * 32 + 8 * fq, pn = u.pn;
        if (pn == 2 || pn == 3) {
            const int cf = (pn - 2) * BM + cw;
            f32x4 l0[2], l1[2];
#pragma unroll
            for (int bj = 0; bj < 2; ++bj) { l0[bj] = *(const f32x4*)(lb + cf + bj * HALF); l1[bj] = *(const f32x4*)(lb + cf + bj * HALF + 4); }
#pragma unroll
            for (int ai = 0; ai < 2; ++ai)
#pragma unroll
                for (int m = 0; m < 4; ++m) { float* rowp = ALOGF + (size_t)(row0 + ai * HALF + m * 16) * 512 + cf;
#pragma unroll
                    for (int bj = 0; bj < 2; ++bj) { f32x4 o0, o1;
#pragma unroll
                        for (int j = 0; j < 4; ++j) { const float f0 = l0[bj][j] + (1.0f - l0[bj][j]) * fast_sigmoid(acc[ai][bj][m][0][j]), f1 = l1[bj][j] + (1.0f - l1[bj][j]) * fast_sigmoid(acc[ai][bj][m][1][j]);
                            o0[j] = __logf(f0); o1[j] = __logf(f1); }
                        *(f32x4*)(rowp + bj * HALF) = o0; *(f32x4*)(rowp + bj * HALF + 4) = o1; } }
            return;
        }
        if (pn == 10) {
#pragma unroll
            for (int ai = 0; ai < 2; ++ai)
#pragma unroll
                for (int m = 0; m < 4; ++m) { const size_t ro = (size_t)(row0 + ai * HALF + m * 16) * 128 + cw;
                    *(u32x4*)(BK + ro) = pack8(acc[ai][0][m][0], acc[ai][0][m][1]); *(u32x4*)(BV + ro) = pack8(acc[ai][1][m][0], acc[ai][1][m][1]); }
            return;
        }
        bf16_t* O; int act; float sc = 1.0f;
        if (pn < 2) { O = AQ; act = 1; } else if (pn < 6) { O = AV; act = 0; } else if (pn < 8) { O = AG; act = 1; } else { O = BQ; act = 0; sc = qscale; }
        const int c0 = (pn & 1) * BM + cw;
#pragma unroll
        for (int ai = 0; ai < 2; ++ai)
#pragma unroll
            for (int m = 0; m < 4; ++m) { bf16_t* rowp = O + (size_t)(row0 + ai * HALF + m * 16) * 512 + c0;
#pragma unroll
                for (int bj = 0; bj < 2; ++bj) { f32x4 v0 = acc[ai][bj][m][0], v1 = acc[ai][bj][m][1];
                    if (act) {
#pragma unroll
                        for (int j = 0; j < 4; ++j) { v0[j] = fast_silu(v0[j]); v1[j] = fast_silu(v1[j]); } }
                    v0 = v0 * sc; v1 = v1 * sc;
                    *(u32x4*)(rowp + bj * HALF) = pack8(v0, v1); } }
    }
};

__device__ __forceinline__ void tile_rowss(const f32x4 (&v)[2][2][4][2], const Unit& u, int wr, int wc, int fr, int fq, PG8_LAS unsigned char* lds, float* ss) {
    PG8_LAS float* P = (PG8_LAS float*)lds;
#pragma unroll
    for (int ai = 0; ai < 2; ++ai)
#pragma unroll
        for (int m = 0; m < 4; ++m) { float s = 0.f;
#pragma unroll
            for (int bj = 0; bj < 2; ++bj)
#pragma unroll
                for (int n = 0; n < 2; ++n) { const f32x4 x = v[ai][bj][m][n]; s += (x[0] * x[0] + x[1] * x[1]) + (x[2] * x[2] + x[3] * x[3]); }
            s += __shfl_xor(s, 16); s += __shfl_xor(s, 32);
            if (fq == 0) P[(ai * HALF + wr * 64 + m * 16 + fr) * 4 + wc] = s; }
    asm volatile("s_waitcnt lgkmcnt(0)" ::: "memory"); __builtin_amdgcn_s_barrier(); asm volatile("" ::: "memory");
    const int t = threadIdx.x;
    if (t < 256) { const f32x4 p = *(const PG8_LAS f32x4*)(P + t * 4); ss[(size_t)(u.pm * BM + t) * 4 + u.pn] = (p[0] + p[1]) + (p[2] + p[3]); }
}
struct EpiOutProj {
    static constexpr bool PERM = true, AFTER_DRAIN = true;
    const float* X; float* Hf; bf16_t* Hb; float* ss;
    __device__ __forceinline__ void fused(f32x4 (&acc)[2][2][4][2], const Unit& u, int wr, int wc, int fr, int fq, PG8_LAS unsigned char* lds, int wid, int lane) const {
        const int row0 = u.pm * BM + wr * 64 + fr, c0 = u.pn * BM + wc * 32 + 8 * fq;
#pragma unroll
        for (int ai = 0; ai < 2; ++ai)
#pragma unroll
            for (int m = 0; m < 4; ++m) { const size_t ro = (size_t)(row0 + ai * HALF + m * 16) * 1024 + c0;
#pragma unroll
                for (int bj = 0; bj < 2; ++bj) { const f32x4 x0 = *(const f32x4*)(X + ro + bj * HALF), x1 = *(const f32x4*)(X + ro + bj * HALF + 4);
                    const f32x4 h0 = acc[ai][bj][m][0] + x0, h1 = acc[ai][bj][m][1] + x1; acc[ai][bj][m][0] = h0; acc[ai][bj][m][1] = h1;
                    *(f32x4*)(Hf + ro + bj * HALF) = h0; *(f32x4*)(Hf + ro + bj * HALF + 4) = h1; *(u32x4*)(Hb + ro + bj * HALF) = pack8(h0, h1); }
                if (m & 1) asm volatile("" ::: "memory"); }
        tile_rowss(acc, u, wr, wc, fr, fq, lds, ss);
    }
};
struct EpiGateUp {
    static constexpr bool PERM = true, AFTER_DRAIN = false;
    bf16_t* ACT; const float* ss; float eps;
    __device__ __forceinline__ void operator()(const f32x4 (&acc)[2][2][4][2], const Unit& u, int wr, int wc, int fr, int fq) const {
        const int row0 = u.pm * BM + wr * 64 + fr, c0 = u.pn * HALF + wc * 32 + 8 * fq;
#pragma unroll
        for (int ai = 0; ai < 2; ++ai)
#pragma unroll
            for (int m = 0; m < 4; ++m) { const int row = row0 + ai * HALF + m * 16; const f32x4 p = *(const f32x4*)(ss + (size_t)row * 4);
                const float rs = __builtin_amdgcn_rsqf(((p[0] + p[1]) + (p[2] + p[3])) * (1.0f / 1024.0f) + eps);
                f32x4 o0, o1;
#pragma unroll
                for (int j = 0; j < 4; ++j) { o0[j] = fast_silu(acc[ai][0][m][0][j] * rs) * (acc[ai][1][m][0][j] * rs); o1[j] = fast_silu(acc[ai][0][m][1][j] * rs) * (acc[ai][1][m][1][j] * rs); }
                *(u32x4*)(ACT + (size_t)row * 2816 + c0) = pack8(o0, o1); }
    }
};
struct EpiDown {
    static constexpr bool PERM = true, AFTER_DRAIN = true;
    float* Hf; float* ss;
    __device__ __forceinline__ void fused(f32x4 (&acc)[2][2][4][2], const Unit& u, int wr, int wc, int fr, int fq, PG8_LAS unsigned char* lds, int wid, int lane) const {
        const int row0 = u.pm * BM + wr * 64 + fr, c0 = u.pn * BM + wc * 32 + 8 * fq;
#pragma unroll
        for (int ai = 0; ai < 2; ++ai)
#pragma unroll
            for (int m = 0; m < 4; ++m) { const size_t ro = (size_t)(row0 + ai * HALF + m * 16) * 1024 + c0;
#pragma unroll
                for (int bj = 0; bj < 2; ++bj) { const f32x4 x0 = *(const f32x4*)(Hf + ro + bj * HALF), x1 = *(const f32x4*)(Hf + ro + bj * HALF + 4);
                    const f32x4 h0 = acc[ai][bj][m][0] + x0, h1 = acc[ai][bj][m][1] + x1; acc[ai][bj][m][0] = h0; acc[ai][bj][m][1] = h1;
                    *(f32x4*)(Hf + ro + bj * HALF) = h0; *(f32x4*)(Hf + ro + bj * HALF + 4) = h1; }
                if (m & 1) asm volatile("" ::: "memory"); }
        tile_rowss(acc, u, wr, wc, fr, fq, lds, ss);
    }
};
template <class Epi, class Sched, bool ALIGN_EPI = false, bool SP2 = false>
__device__ __forceinline__ void gemm_phase(PG8_LAS unsigned char* lds, const Gemm g, const Sched& S, const Epi& E) {
    const int tid = threadIdx.x, wid = __builtin_amdgcn_readfirstlane(tid >> 6), lane = tid & 63, wr = wid >> 2, wc = wid & 3, fr = lane & 15, fq = lane >> 4;
    const int K = g.K, nt = K / BK;
    unsigned voffA[2], voffB[2];
#pragma unroll
    for (int i = 0; i < 2; ++i) { int R, C; stage_rc(tid * 16 + i * 8192, R, C); const int Rb = Epi::PERM ? ((R & ~31) + perm32(R & 31)) : R;
        voffA[i] = (unsigned)(R * K + C) * 2u; voffB[i] = (unsigned)(Rb * K + C) * 2u; }
    const size_t kstep = (size_t)(BK * 2);
    const size_t hstep = (size_t)HALF * K * 2;
    const size_t tstep = 2 * hstep;
    const unsigned ldsw = (unsigned)wid * 1024u;
    const int aoff = lds_byte(wr * 64 + fr, fq * 8), boff = lds_byte(wc * 32 + fr, fq * 8);
#define PG8_SA(b, h) (((b) * 2 + (h)) * HTB)
#define PG8_SB(b, h) ((4 + (b) * 2 + (h)) * HTB)
#define PG8_STAGE(bufoff, gbase, voff) do { _Pragma("unroll") for (int _i = 0; _i < 2; ++_i) \
        __builtin_amdgcn_global_load_lds((const unsigned*)((const char*)(gbase) + (voff)[_i]), (PG8_LAS unsigned*)(lds + (bufoff) + ldsw + _i * 8192), 16, 0, 0); } while (0)
#define PG8_LDA(dst, b, h) do { _Pragma("unroll") for (int m = 0; m < 4; ++m) _Pragma("unroll") for (int k = 0; k < 2; ++k) dst[m][k] = *(const PG8_LAS bf16x8*)(lds + PG8_SA(b, h) + aoff + m * 2048 + k * 1024); } while (0)
#define PG8_LDB(dst, b, h) do { _Pragma("unroll") for (int n = 0; n < 2; ++n) _Pragma("unroll") for (int k = 0; k < 2; ++k) dst[n][k] = *(const PG8_LAS bf16x8*)(lds + PG8_SB(b, h) + boff + n * 2048 + k * 1024); } while (0)
#define PG8_MMA(ai, bj, At, Bt) do { __builtin_amdgcn_s_setprio(1); _Pragma("unroll") for (int m = 0; m < 4; ++m) _Pragma("unroll") for (int n = 0; n < 2; ++n) _Pragma("unroll") for (int k = 0; k < 2; ++k) \
        acc[ai][bj][m][n] = __builtin_amdgcn_mfma_f32_16x16x32_bf16(Bt[n][k], At[m][k], acc[ai][bj][m][n], 0, 0, 0); __builtin_amdgcn_s_setprio(0); } while (0)
#define PG8_WAIT_V(n) asm volatile("s_waitcnt vmcnt(" #n ")" ::: "memory")
#define PG8_WAIT_L(n) asm volatile("s_waitcnt lgkmcnt(" #n ")" ::: "memory")
#define PG8_BAR __builtin_amdgcn_s_barrier()
#define PG8_SCHED __builtin_amdgcn_sched_barrier(0)
    Unit cur, nxt; int ui = 0;
    if (!S.next(0, cur)) return;
    f32x4 acc[2][2][4][2];
#pragma unroll
    for (int a = 0; a < 2; ++a)
#pragma unroll
        for (int b = 0; b < 2; ++b)
#pragma unroll
            for (int m = 0; m < 4; ++m)
#pragma unroll
                for (int n = 0; n < 2; ++n) acc[a][b][m][n] = (f32x4){0.f, 0.f, 0.f, 0.f};
    bf16x8 At[4][2], B0[2][2], B1[2][2];
    const char* cA = (const char*)g.A + (size_t)cur.pm * tstep; const char* cB = (const char*)g.Bt + (size_t)cur.pn * tstep;
    S.a_ready(cur);
    if constexpr (SP2) {
        PG8_STAGE(PG8_SB(0, 0), cB, voffB); PG8_STAGE(PG8_SB(0, 1), cB + hstep, voffB); PG8_STAGE(PG8_SA(0, 0), cA, voffA); PG8_STAGE(PG8_SA(0, 1), cA + hstep, voffA);
        if (wr == 1) PG8_BAR;
        PG8_WAIT_V(2); PG8_BAR;
        PG8_STAGE(PG8_SB(1, 0), cB + kstep, voffB); PG8_STAGE(PG8_SA(1, 0), cA + kstep, voffA); PG8_STAGE(PG8_SB(1, 1), cB + hstep + kstep, voffB);
        PG8_WAIT_V(6); PG8_BAR;
    } else {
        PG8_STAGE(PG8_SB(0, 0), cB, voffB); PG8_STAGE(PG8_SA(0, 0), cA, voffA); PG8_STAGE(PG8_SB(0, 1), cB + hstep, voffB); PG8_STAGE(PG8_SA(0, 1), cA + hstep, voffA);
        if (wr == 1) PG8_BAR;
        PG8_WAIT_V(4); PG8_BAR;
        PG8_STAGE(PG8_SB(1, 0), cB + kstep, voffB); PG8_STAGE(PG8_SA(1, 0), cA + kstep, voffA); PG8_STAGE(PG8_SB(1, 1), cB + hstep + kstep, voffB);
        PG8_WAIT_V(6); PG8_BAR;
    }
    for (;;) {
        const bool has_next = S.next(ui + 1, nxt);
        const char* nA = has_next ? (const char*)g.A + (size_t)nxt.pm * tstep : cA; const char* nB = has_next ? (const char*)g.Bt + (size_t)nxt.pn * tstep : cB;
        for (int t = 0; t < nt; t += 2) {
            const bool last = (t == nt - 2);
            const char* a1 = cA + (size_t)(t + 1) * kstep;
            const char* a2 = last ? nA : cA + (size_t)(t + 2) * kstep; const char* b2 = last ? nB : cB + (size_t)(t + 2) * kstep;
            const char* a3 = a2 + kstep; const char* b3 = b2 + kstep;
            if (last && has_next) S.a_ready(nxt);
            if constexpr (SP2) {
            PG8_LDB(B0, 0, 0); PG8_LDB(B1, 0, 1); PG8_SCHED; PG8_LDA(At, 0, 0); PG8_STAGE(PG8_SA(1, 1), a1 + hstep, voffA);
            PG8_WAIT_V(8); PG8_WAIT_L(0); PG8_BAR; PG8_MMA(0, 0, At, B0); PG8_MMA(0, 1, At, B1); PG8_BAR; PG8_SCHED;
            PG8_LDA(At, 0, 1); PG8_STAGE(PG8_SB(0, 0), b2, voffB); PG8_STAGE(PG8_SB(0, 1), b2 + hstep, voffB); PG8_STAGE(PG8_SA(0, 0), a2, voffA);
            PG8_WAIT_V(8); PG8_WAIT_L(0); PG8_BAR; PG8_MMA(1, 0, At, B0); PG8_MMA(1, 1, At, B1); PG8_BAR; PG8_SCHED;
            PG8_LDB(B0, 1, 0); PG8_LDB(B1, 1, 1); PG8_SCHED; PG8_LDA(At, 1, 0); PG8_STAGE(PG8_SA(0, 1), a2 + hstep, voffA);
            PG8_WAIT_V(8); PG8_WAIT_L(0); PG8_BAR; PG8_MMA(0, 0, At, B0); PG8_MMA(0, 1, At, B1); PG8_BAR; PG8_SCHED;
            PG8_LDA(At, 1, 1); PG8_STAGE(PG8_SB(1, 0), b3, voffB); PG8_STAGE(PG8_SB(1, 1), b3 + hstep, voffB); PG8_STAGE(PG8_SA(1, 0), a3, voffA);
            PG8_WAIT_V(8); PG8_WAIT_L(0); PG8_BAR; PG8_MMA(1, 0, At, B0); PG8_MMA(1, 1, At, B1); PG8_BAR; PG8_SCHED;
            } else {
            PG8_LDB(B0, 0, 0); PG8_SCHED; PG8_LDA(At, 0, 0); PG8_STAGE(PG8_SA(1, 1), a1 + hstep, voffA);
            PG8_WAIT_L(8); PG8_BAR; PG8_WAIT_L(0); PG8_MMA(0, 0, At, B0); PG8_BAR; PG8_SCHED;
            PG8_LDB(B1, 0, 1); PG8_STAGE(PG8_SB(0, 0), b2, voffB);
            PG8_BAR; PG8_WAIT_L(0); PG8_MMA(0, 1, At, B1); PG8_BAR;
            PG8_LDA(At, 0, 1); PG8_STAGE(PG8_SA(0, 0), a2, voffA);
            PG8_BAR; PG8_WAIT_L(0); PG8_MMA(1, 0, At, B0); PG8_BAR; PG8_SCHED;
            PG8_STAGE(PG8_SB(0, 1), b2 + hstep, voffB);
            PG8_WAIT_V(6); PG8_BAR; PG8_MMA(1, 1, At, B1); PG8_BAR;
            PG8_LDB(B0, 1, 0); PG8_SCHED; PG8_LDA(At, 1, 0); PG8_STAGE(PG8_SA(0, 1), a2 + hstep, voffA);
            PG8_WAIT_L(8); PG8_BAR; PG8_WAIT_L(0); PG8_MMA(0, 0, At, B0); PG8_BAR; PG8_SCHED;
            PG8_LDB(B1, 1, 1); PG8_STAGE(PG8_SB(1, 0), b3, voffB);
            PG8_BAR; PG8_WAIT_L(0); PG8_MMA(0, 1, At, B1); PG8_BAR;
            PG8_LDA(At, 1, 1); PG8_STAGE(PG8_SA(1, 0), a3, voffA);
            PG8_BAR; PG8_WAIT_L(0); PG8_MMA(1, 0, At, B0); PG8_BAR; PG8_SCHED;
            PG8_STAGE(PG8_SB(1, 1), b3 + hstep, voffB);
            PG8_WAIT_V(6); PG8_BAR; PG8_MMA(1, 1, At, B1); PG8_BAR;
            }
        }
        if constexpr (ALIGN_EPI) { if (wr == 0) PG8_BAR; }
        if constexpr (!Epi::AFTER_DRAIN) { E(acc, cur, wr, wc, fr, fq); S.done(cur); }
        if (!has_next) break;
#pragma unroll
        for (int a = 0; a < 2; ++a)
#pragma unroll
            for (int b = 0; b < 2; ++b)
#pragma unroll
                for (int m = 0; m < 4; ++m)
#pragma unroll
                    for (int n = 0; n < 2; ++n) acc[a][b][m][n] = (f32x4){0.f, 0.f, 0.f, 0.f};
        cur = nxt; cA = nA; cB = nB; ++ui;
        if constexpr (ALIGN_EPI) { if (wr == 1) PG8_BAR; }
    }
    PG8_WAIT_V(0);
    if constexpr (!ALIGN_EPI) { if (wr == 0) PG8_BAR; }
    PG8_BAR;
    if constexpr (Epi::AFTER_DRAIN) { E.fused(acc, cur, wr, wc, fr, fq, lds, wid, lane); S.done(cur); }
#undef PG8_SA
#undef PG8_SB
#undef PG8_STAGE
#undef PG8_LDA
#undef PG8_LDB
#undef PG8_MMA
#undef PG8_WAIT_V
#undef PG8_WAIT_L
#undef PG8_BAR
#undef PG8_SCHED
}
}
#ifndef PG8_SP2
#define PG8_SP2 true
#endif
#ifndef PG8_ALIGN
#define PG8_ALIGN true
#endif
constexpr int NWAVES = 8;
constexpr int BATCH = 2, SEQ = 8192, DM = 1024, M = BATCH * SEQ, INC = 2816, DFF = 2816;
constexpr int AH = 4, BHEADS = 8;
constexpr float EPS = 1e-6f, LOG2E = 1.4426950408889634f;
constexpr float QSCALE = 0.125f * LOG2E;
constexpr int NSEG = 32, SEGCH = 4;
constexpr size_t MiB = 1u << 20;
constexpr size_t WS_CTL = 0, CTL_ZERO_BYTES = 256 * 1024;
constexpr size_t WS_LB = 1 * MiB, WS_SS2 = WS_LB + 64 * 1024, WS_SS3 = WS_SS2 + 256 * 1024, WS_DSEG = WS_SS3 + 256 * 1024;
constexpr size_t WS_WIN = 2 * MiB, WS_WO = 8 * MiB, WS_WGU = 10 * MiB, WS_WD = 21 * MiB;
constexpr size_t WS_SLOC = 27 * MiB, WS_SIN = 43 * MiB;
constexpr size_t WS_XN = 60 * MiB;
constexpr size_t WS_AQ = 92 * MiB, WS_ALOGF = 108 * MiB, WS_AV = 140 * MiB, WS_AG = 156 * MiB, WS_BQ = 172 * MiB, WS_BK = 188 * MiB, WS_BV = 192 * MiB;
constexpr size_t WS_MIX = 196 * MiB;
constexpr size_t WS_ACT = 92 * MiB;
constexpr size_t WS_END = 228 * MiB;
static_assert(WS_WIN + (size_t)INC * DM * 2 <= WS_WO && WS_WO + (size_t)DM * DM * 2 <= WS_WGU && WS_WGU + (size_t)2 * DFF * DM * 2 <= WS_WD && WS_WD + (size_t)DM * DFF * 2 <= WS_SLOC, "weight map");
static_assert(WS_ACT + (size_t)M * DFF * 2 <= WS_MIX && WS_DSEG + 8 * 32 * 128 * 4 <= WS_WIN, "ws map");
constexpr int CW_BAR = 4096;

constexpr int RING_OFF = 0, RING_BYTES = 131072;
constexpr int LDSCTL_OFF = RING_BYTES, MISC_OFF = LDSCTL_OFF + 320;
constexpr int LDS_BYTES = 147456;
#define GAS __attribute__((address_space(1)))
#define LAS __attribute__((address_space(3)))
typedef unsigned short bf16;
typedef unsigned v4u __attribute__((ext_vector_type(4)));
typedef float f32x4 __attribute__((ext_vector_type(4)));
typedef short bf16x8 __attribute__((ext_vector_type(8)));
typedef GAS unsigned gu32;
typedef GAS unsigned long long gu64;
#define RLX_AGENT __ATOMIC_RELAXED, __HIP_MEMORY_SCOPE_AGENT
#define LDS_WAIT() asm volatile("s_waitcnt lgkmcnt(0)" ::: "memory")
#define VM_WAIT() asm volatile("s_waitcnt vmcnt(0)" ::: "memory")
__device__ __forceinline__ unsigned long long rt() { return __builtin_amdgcn_s_memrealtime(); }
__device__ __forceinline__ unsigned f2bf(float f) { unsigned u = __builtin_bit_cast(unsigned, f); return (u + 0x7fffu + ((u >> 16) & 1u)) >> 16; }
__device__ __forceinline__ unsigned pk2(float lo, float hi) { return f2bf(lo) | (f2bf(hi) << 16); }

#define XB_TMO      128
#define XB_XCNT(j)  (256  + 64 * (j))
#define XB_XSUB(j)  (1280 + 64 * (j))
#define XB_XGEN(j)  (2304 + 64 * (j))
#define XB_TOP      3328
#define XB_TOPGEN   3392
#define XCD_BAR_WORDS 3456
#define XB_SPIN_CAP (1u << 18)

__device__ __forceinline__ unsigned xb_ld(unsigned* p)              { return __hip_atomic_load(p, __ATOMIC_RELAXED, __HIP_MEMORY_SCOPE_AGENT); }
__device__ __forceinline__ unsigned xb_add(unsigned* p, unsigned v) { return __hip_atomic_fetch_add(p, v, __ATOMIC_RELAXED, __HIP_MEMORY_SCOPE_AGENT); }
__device__ __forceinline__ unsigned xb_xcc_id() { return (unsigned)__builtin_amdgcn_s_getreg((3 << 11) | 20) & 0xFu; }
#define XB_SPIN(cond, bar) do { unsigned _sp = 0; while (cond) { __builtin_amdgcn_s_sleep(1); \
    if ((++_sp & 255u) == 0u) { if (xb_ld(&(bar)[XB_TMO])) break; if (_sp > XB_SPIN_CAP) { atomicAdd(&(bar)[XB_TMO], 1u); break; } } } } while (0)

struct XcdBarrier {
    unsigned* bar; unsigned x;
    volatile LAS unsigned* st;
};

__device__ __forceinline__ XcdBarrier xcd_barrier_post(unsigned* bar, volatile LAS unsigned* st) {
    XcdBarrier b; b.bar = bar; b.x = xb_xcc_id(); b.st = st;
    if (threadIdx.x == 0) (void)xb_add(&bar[XB_XCNT(b.x)], 1u);
    return b;
}
__device__ __forceinline__ void xcd_barrier_complete(unsigned* bar, unsigned x, unsigned& nloc, unsigned& nx) {
    const unsigned G = gridDim.x * gridDim.y * gridDim.z;
    unsigned sum, cnt, mine, sp = 0u;
    for (;;) {
        sum = 0u; cnt = 0u; mine = 0u;
#pragma unroll
        for (unsigned j = 0; j < 16; ++j) { const unsigned c = xb_ld(&bar[XB_XCNT(j)]); sum += c; cnt += (c > 0u) ? 1u : 0u; mine = (j == x) ? c : mine; }
        if (sum == G) break;
        __builtin_amdgcn_s_sleep(1);
        if ((++sp & 255u) == 0u) { if (xb_ld(&bar[XB_TMO])) break; if (sp > XB_SPIN_CAP) { atomicAdd(&bar[XB_TMO], 1u); break; } }
    }
    nloc = mine > 0u ? mine : 1u; nx = cnt > 0u ? cnt : 1u;
}

__device__ __forceinline__ void xcd_barrier(const XcdBarrier& b) {
    asm volatile("s_waitcnt vmcnt(0)" ::: "memory");
    __syncthreads();
    if (threadIdx.x == 0) {
        unsigned* bar = b.bar;
        __builtin_amdgcn_s_waitcnt(0);
        unsigned nloc = b.st[0], nx = b.st[1];
        if (nloc == 0u) { xcd_barrier_complete(bar, b.x, nloc, nx); b.st[0] = nloc; b.st[1] = nx; }
        const unsigned old = xb_add(&bar[XB_XSUB(b.x)], 1u);
        const unsigned gen = old / nloc;
        if (old + 1u == (gen + 1u) * nloc) {
            __builtin_amdgcn_fence(__ATOMIC_RELEASE, "agent");
            asm volatile("s_waitcnt vmcnt(0)" ::: "memory");
            const unsigned og = xb_add(&bar[XB_TOP], 1u);
            const unsigned tg = og / nx;
            if (og + 1u == (tg + 1u) * nx) xb_add(&bar[XB_TOPGEN], 1u);
            else XB_SPIN(xb_ld(&bar[XB_TOPGEN]) == tg, bar);
            __builtin_amdgcn_fence(__ATOMIC_ACQUIRE, "agent");
            xb_add(&bar[XB_XGEN(b.x)], 1u);
            asm volatile("s_waitcnt vmcnt(0)" ::: "memory");
        } else {
            XB_SPIN(xb_ld(&bar[XB_XGEN(b.x)]) == gen, bar);
            __builtin_amdgcn_fence(__ATOMIC_ACQUIRE, "agent");
            asm volatile("s_waitcnt vmcnt(0)" ::: "memory");
        }
    }
    __syncthreads();
}
struct Frame {
    LAS unsigned char* lds;
    volatile LAS unsigned* MISC;
    gu32* ctl;
    int tid, lane, wave;
    int vcu, G;
    const float *x, *ln1_g, *w_in, *lb_logits, *hgrn_norm_g, *attn_sinks, *attn_norm_g, *w_out, *ln2_g, *w_gate, *w_up, *w_down, *final_g;
    float* out;
    unsigned char* ws;
};
__device__ __forceinline__ float wave_sum(float v) {
#pragma unroll
    for (int o = 1; o < 64; o <<= 1) v += __shfl_xor(v, o);
    return v;
}
__device__ __forceinline__ void p0_transpose_item(const float* W, int K, int N, bf16* WT, int dst_row0, const float* gk, LAS float* scr, int k0, int n0, int lane) {
#pragma unroll 8
    for (int i = 0; i < 32; ++i) { const int kk = 2 * i + (lane >> 5); float w = W[(size_t)(k0 + kk) * N + n0 + (lane & 31)]; if (gk) w *= gk[k0 + kk]; scr[kk * 33 + (lane & 31)] = w; }
    LDS_WAIT(); asm volatile("" ::: "memory");
    const int c = lane & 7;
#pragma unroll
    for (int j = 0; j < 4; ++j) { const int n = (lane >> 3) + 8 * j; const LAS float* s = scr + (8 * c) * 33 + n;
        v4u o; o.x = pk2(s[0 * 33], s[1 * 33]); o.y = pk2(s[2 * 33], s[3 * 33]); o.z = pk2(s[4 * 33], s[5 * 33]); o.w = pk2(s[6 * 33], s[7 * 33]);
        *(GAS v4u*)(WT + (size_t)(dst_row0 + n) * K + k0 + 8 * c) = o; }
    LDS_WAIT(); asm volatile("" ::: "memory");
}
__device__ __forceinline__ void rms_row_to_bf16(const float* xrow, const float* g, bf16* orow, int lane) {
    const GAS f32x4* xr = (const GAS f32x4*)xrow + lane;
    f32x4 v[4]; float s = 0.f;
#pragma unroll
    for (int j = 0; j < 4; ++j) { v[j] = xr[64 * j]; s += (v[j].x * v[j].x + v[j].y * v[j].y) + (v[j].z * v[j].z + v[j].w * v[j].w); }
    const float rstd = 1.f / sqrtf(wave_sum(s) * (1.f / DM) + EPS);
    GAS unsigned long long* o8 = (GAS unsigned long long*)orow + lane;
#pragma unroll
    for (int j = 0; j < 4; ++j) { const f32x4 gg = ((const GAS f32x4*)g)[lane + 64 * j];
        o8[64 * j] = (unsigned long long)pk2(v[j].x * rstd * gg.x, v[j].y * rstd * gg.y) | ((unsigned long long)pk2(v[j].z * rstd * gg.z, v[j].w * rstd * gg.w) << 32); }
}
__device__ __forceinline__ void p0_prologue(Frame& F) {
    LAS float* scr = (LAS float*)(F.lds + RING_OFF + F.wave * 16384);
    const int gw = F.vcu * NWAVES + F.wave, NGW = F.G * NWAVES;
    bf16* Win_t = (bf16*)(F.ws + WS_WIN); bf16* Wo_t = (bf16*)(F.ws + WS_WO); bf16* Wgu_t = (bf16*)(F.ws + WS_WGU); bf16* Wd_t = (bf16*)(F.ws + WS_WD);
    constexpr int I_IN = (DM / 64) * (INC / 32), I_O = (DM / 64) * (DM / 32), I_G = (DM / 64) * (DFF / 32), I_D = (DFF / 64) * (DM / 32);
    constexpr int NITEMS = I_IN + I_O + 2 * I_G + I_D;
    for (int it = gw; it < NITEMS; it += NGW) {
        int r = it;
        if (r < I_IN) { const int nb = INC / 32, k0 = 64 * (r / nb), n0 = 32 * (r % nb); p0_transpose_item(F.w_in, DM, INC, Win_t, n0, nullptr, scr, k0, n0, F.lane); continue; } r -= I_IN;
        if (r < I_O) { const int nb = DM / 32, k0 = 64 * (r / nb), n0 = 32 * (r % nb); p0_transpose_item(F.w_out, DM, DM, Wo_t, n0, nullptr, scr, k0, n0, F.lane); continue; } r -= I_O;
        if (r < 2 * I_G) { const bool up = r >= I_G; if (up) r -= I_G; const int nb = DFF / 32, k0 = 64 * (r / nb), n0 = 32 * (r % nb);
            const int dst = (n0 >> 7) * 256 + (up ? 128 : 0) + (n0 & 127);
            p0_transpose_item(up ? F.w_up : F.w_gate, DM, DFF, Wgu_t, dst, F.ln2_g, scr, k0, n0, F.lane); continue; } r -= 2 * I_G;
        { const int nb = DM / 32, k0 = 64 * (r / nb), n0 = 32 * (r % nb); p0_transpose_item(F.w_down, DFF, DM, Wd_t, n0, nullptr, scr, k0, n0, F.lane); }
    }
    bf16* XN = (bf16*)(F.ws + WS_XN);
    for (int m = gw; m < M; m += NGW) rms_row_to_bf16(F.x + (size_t)m * DM, F.ln1_g, XN + (size_t)m * DM, F.lane);
    if (blockIdx.x == 0) {
        float* lb = (float*)(F.ws + WS_LB); const int k = F.tid;
        const float a = F.lb_logits[k], b = F.lb_logits[512 + k], mx = fmaxf(a, b), ea = __expf(a - mx), eb = __expf(b - mx); lb[k] = ea / (ea + eb);
    }
}
__device__ __forceinline__ void final_norm(Frame& F) {
    const int gw = F.vcu * NWAVES + F.wave, NGW = F.G * NWAVES; const float* ss = (const float*)(F.ws + WS_SS3);
    for (int m = gw; m < M; m += NGW) {
        const f32x4 p = *(const GAS f32x4*)(ss + (size_t)m * 4); const float rs = 1.f / sqrtf(((p.x + p.y) + (p.z + p.w)) * (1.f / DM) + EPS);
        GAS f32x4* o = (GAS f32x4*)(F.out + (size_t)m * DM) + F.lane;
#pragma unroll
        for (int j = 0; j < 4; ++j) { const f32x4 gg = ((const GAS f32x4*)F.final_g)[F.lane + 64 * j]; f32x4 v = o[64 * j]; v.x *= rs * gg.x; v.y *= rs * gg.y; v.z *= rs * gg.z; v.w *= rs * gg.w; o[64 * j] = v; }
    }
}
namespace mx {
typedef short bf16x8 __attribute__((ext_vector_type(8)));
typedef short s16x4 __attribute__((ext_vector_type(4)));
typedef float f32x16 __attribute__((ext_vector_type(16)));
typedef float f32x4 __attribute__((ext_vector_type(4)));
typedef float f32x2_t __attribute__((ext_vector_type(2))); typedef __bf16 bf16x2_t __attribute__((ext_vector_type(2)));
__device__ __forceinline__ unsigned cvtpk(float lo, float hi) { f32x2_t v = {lo, hi}; bf16x2_t b = __builtin_convertvector(v, bf16x2_t); return __builtin_bit_cast(unsigned, b); }
__device__ __forceinline__ s16x4 vtr(const LAS unsigned char* p) { return __builtin_bit_cast(s16x4, __builtin_amdgcn_ds_read_tr16_b64_v4i16((LAS s16x4*)p)); }
__device__ __forceinline__ int crow(int r, int hi) { return (r & 3) + 8 * (r >> 2) + 4 * hi; }
__device__ __forceinline__ float bf2f(bf16 v) { return __uint_as_float((unsigned)v << 16); }
#define MFMA32(a, b, c) __builtin_amdgcn_mfma_f32_32x32x16_bf16((a), (b), (c), 0, 0, 0)
#define MFMA16(a, b, c) __builtin_amdgcn_mfma_f32_16x16x32_bf16((a), (b), (c), 0, 0, 0)

constexpr int SW_V = 0, SW_OST = 49152, SW_HS = SW_OST + 65536, SW_WSF = SW_HS + 2048, SW_END = SW_WSF + 2048;
static_assert(SW_END <= RING_BYTES, "swa lds");
__device__ __forceinline__ void swa_unit(Frame& F, int b, int qblk) {
    const int tid = F.tid, lane = F.lane, wid = F.wave, r32 = lane & 31, hi = lane >> 5;
    const int t0 = qblk * 64; const size_t rowb = (size_t)b * SEQ;
    const bf16* BQ = (const bf16*)(F.ws + WS_BQ); const bf16* BK = (const bf16*)(F.ws + WS_BK); const bf16* BV = (const bf16*)(F.ws + WS_BV); bf16* MIX = (bf16*)(F.ws + WS_MIX);
    LAS unsigned char* lds = F.lds + RING_OFF;
#pragma unroll
    for (int i = 0; i < 6; ++i) { const int c = tid + 512 * i, key = c >> 4, c16 = c & 15; int tk = t0 - 128 + key; tk = tk < 0 ? 0 : tk;
        const v4u val = *(const GAS v4u*)(BV + (rowb + tk) * 128 + c16 * 8);
        *(LAS v4u*)(lds + SW_V + (c16 >> 2) * 12288 + key * 64 + (c16 & 3) * 16) = val; }
    __syncthreads();
    const int hd = wid, kvh = hd >> 2;
    const float slope2 = exp2f(-(float)(hd + 1)) * LOG2E, sink2 = F.attn_sinks[hd] * LOG2E;
    LAS float* ost = (LAS float*)(lds + SW_OST + wid * 8192);
    LAS float* hs = (LAS float*)(lds + SW_HS);
    LAS float* wsf = (LAS float*)(lds + SW_WSF + wid * 256);
    const LAS unsigned char* vlane = lds + SW_V + (kvh * 2) * 12288 + (4 * hi + ((lane & 15) >> 2)) * 64 + ((lane >> 4) & 1) * 32 + (lane & 3) * 8;
    f32x4 g0 = *(const GAS f32x4*)(F.attn_norm_g + hd * 64 + (lane & 7) * 8), g1 = *(const GAS f32x4*)(F.attn_norm_g + hd * 64 + (lane & 7) * 8 + 4);
#pragma unroll 1
    for (int qb = 0; qb < 2; ++qb) {
        const int tq0 = t0 + 32 * qb;
        bf16x8 qf[4];
#pragma unroll
        for (int ks = 0; ks < 4; ++ks) qf[ks] = *(const GAS bf16x8*)(BQ + (rowb + tq0 + r32) * 512 + hd * 64 + 16 * ks + 8 * hi);
        f32x16 s[5];
#pragma unroll
        for (int kbi = 0; kbi < 5; ++kbi) {
            const int kabs0 = t0 - 128 + 32 * (qb + kbi); int krow = kabs0 + r32; krow = krow < 0 ? 0 : krow;
            bf16x8 kf[4];
#pragma unroll
            for (int ks = 0; ks < 4; ++ks) kf[ks] = *(const GAS bf16x8*)(BK + (rowb + krow) * 128 + kvh * 64 + 16 * ks + 8 * hi);
            f32x16 acc = {};
#pragma unroll
            for (int ks = 0; ks < 4; ++ks) acc = MFMA32(kf[ks], qf[ks], acc);
#pragma unroll
            for (int r = 0; r < 16; ++r) { const int key = kabs0 + crow(r, hi), dist = (tq0 + r32) - key; const bool ok = (dist >= 0) && (dist < 128) && (key >= 0);
                s[kbi][r] = ok ? acc[r] - slope2 * (float)dist : -INFINITY; }
        }
        float mx_ = sink2;
#pragma unroll
        for (int kbi = 0; kbi < 5; ++kbi)
#pragma unroll
            for (int r = 0; r < 16; ++r) mx_ = fmaxf(mx_, s[kbi][r]);
        mx_ = fmaxf(mx_, __shfl_xor(mx_, 32));
        float lsum = 0.f;
#pragma unroll
        for (int kbi = 0; kbi < 5; ++kbi)
#pragma unroll
            for (int r = 0; r < 16; ++r) { const float p = __builtin_amdgcn_exp2f(s[kbi][r] - mx_); s[kbi][r] = p; lsum += p; }
        lsum += __shfl_xor(lsum, 32);
        const float ltot = lsum + __builtin_amdgcn_exp2f(sink2 - mx_);
        f32x16 o[2] = {};
#pragma unroll
        for (int kbi = 0; kbi < 5; ++kbi)
#pragma unroll
            for (int st = 0; st < 2; ++st) {
                v4u pw; pw.x = cvtpk(s[kbi][8 * st + 0], s[kbi][8 * st + 1]); pw.y = cvtpk(s[kbi][8 * st + 2], s[kbi][8 * st + 3]); pw.z = cvtpk(s[kbi][8 * st + 4], s[kbi][8 * st + 5]); pw.w = cvtpk(s[kbi][8 * st + 6], s[kbi][8 * st + 7]);
                const bf16x8 pa = __builtin_bit_cast(bf16x8, pw);
                const LAS unsigned char* vp = vlane + (32 * (qb + kbi) + 16 * st) * 64;
#pragma unroll
                for (int d0 = 0; d0 < 2; ++d0) { const s16x4 lo = vtr(vp + d0 * 12288), hh = vtr(vp + d0 * 12288 + 512);
                    const bf16x8 vf = {lo[0], lo[1], lo[2], lo[3], hh[0], hh[1], hh[2], hh[3]};
                    o[d0] = MFMA32(pa, vf, o[d0]); }
            }
        if (hi == 0) wsf[r32] = ltot;
        float rli[16];
#pragma unroll
        for (int r = 0; r < 16; ++r) rli[r] = __builtin_amdgcn_rcpf(wsf[crow(r, hi)]);
#pragma unroll
        for (int r = 0; r < 16; ++r) { ost[crow(r, hi) * 64 + r32] = o[0][r] * rli[r]; ost[crow(r, hi) * 64 + 32 + r32] = o[1][r] * rli[r]; }
        f32x4 va[4], vb[4];
#pragma unroll
        for (int i = 0; i < 4; ++i) { const int row = i * 8 + (lane >> 3); va[i] = *(const LAS f32x4*)(ost + row * 64 + (lane & 7) * 8); vb[i] = *(const LAS f32x4*)(ost + row * 64 + (lane & 7) * 8 + 4);
            float q = (va[i][0] * va[i][0] + va[i][1] * va[i][1]) + (va[i][2] * va[i][2] + va[i][3] * va[i][3]) + (vb[i][0] * vb[i][0] + vb[i][1] * vb[i][1]) + (vb[i][2] * vb[i][2] + vb[i][3] * vb[i][3]);
            q += __shfl_xor(q, 1); q += __shfl_xor(q, 2); q += __shfl_xor(q, 4);
            if ((lane & 7) == 0) hs[(32 * qb + row) * 8 + hd] = q; }
        __syncthreads();
#pragma unroll
        for (int i = 0; i < 4; ++i) { const int row = i * 8 + (lane >> 3);
            const f32x4 h0 = *(const LAS f32x4*)(hs + (32 * qb + row) * 8), h1 = *(const LAS f32x4*)(hs + (32 * qb + row) * 8 + 4);
            const float rs = __builtin_amdgcn_rsqf(((h0[0] + h0[1]) + (h0[2] + h0[3]) + (h1[0] + h1[1]) + (h1[2] + h1[3])) * (1.0f / 512.0f) + EPS);
            const f32x4 y0 = va[i] * rs * g0, y1 = vb[i] * rs * g1;
            v4u w; w.x = cvtpk(y0[0], y0[1]); w.y = cvtpk(y0[2], y0[3]); w.z = cvtpk(y1[0], y1[1]); w.w = cvtpk(y1[2], y1[3]);
            *(GAS v4u*)(MIX + (rowb + tq0 + row) * 1024 + 512 + hd * 64 + (lane & 7) * 8) = w; }
    }
    __syncthreads();
}
__device__ __forceinline__ void swa_phase(Frame& F) {
    for (int u = F.vcu; u < BATCH * (SEQ / 64); u += F.G) swa_unit(F, u / (SEQ / 64), u % (SEQ / 64));
}
}
namespace mx {
constexpr int HG_PT = 144, HG_PV = 272, HG_PO = 528;
constexpr int HG_QD = 0, HG_KI = HG_QD + 128 * HG_PT, HG_KS = HG_KI + 128 * HG_PT, HG_VV = HG_KS + 128 * HG_PT, HG_AA = HG_VV + 64 * HG_PV, HG_OUT = HG_AA + 64 * HG_PT,
              HG_DEC = HG_OUT + 64 * HG_PO, HG_QSUM = HG_DEC + 512, HG_SSQ = HG_QSUM + 2048, HG_END = HG_SSQ + 2048;
static_assert(HG_END <= RING_BYTES, "hgrn lds");
#define HG_BAR() __syncthreads()
template <int MODE  >
__device__ __forceinline__ void hgrn_unit(Frame& F, int bh, int g) {
    const int tid = F.tid, lane = F.lane, w = F.wave, fr = lane & 15, fq = lane >> 4, q_ = fr >> 2, p_ = lane & 3;
    const int b = bh >> 2, h = bh & 3;
    LAS unsigned char* lds = F.lds + RING_OFF;
    const bf16* AQ = (const bf16*)(F.ws + WS_AQ); const float* ALOGF = (const float*)(F.ws + WS_ALOGF); const bf16* AV = (const bf16*)(F.ws + WS_AV); const bf16* AG = (const bf16*)(F.ws + WS_AG);
    bf16* MIX = (bf16*)(F.ws + WS_MIX);
    float* SLOC = (float*)(F.ws + WS_SLOC); const float* SIN = (const float*)(F.ws + WS_SIN); float* DSEG = (float*)(F.ws + WS_DSEG);
    const size_t frag_base = ((size_t)(bh * NSEG + g) * 8 + w) * 2048 + lane;
    f32x4 st[8];
#pragma unroll
    for (int kt = 0; kt < 8; ++kt)
#pragma unroll
        for (int r = 0; r < 4; ++r) st[kt][r] = (MODE == 1) ? SIN[frag_base + (kt * 4 + r) * 64] : 0.f;
    const int pk = tid & 127, pq = tid >> 7;
    float seglog = 0.f;
#pragma unroll 1
    for (int ch = 0; ch < SEGCH; ++ch) {
        const size_t tokb = (size_t)b * SEQ + (size_t)(g * SEGCH + ch) * 64;
        float lf[16], cs[16];
        { const float* lp = ALOGF + (tokb + 16 * pq) * 512 + h * 128 + pk;
#pragma unroll
          for (int i = 0; i < 16; ++i) lf[i] = lp[(size_t)i * 512]; }
        float qv[16];
        if (MODE == 1) { const bf16* qp = AQ + (tokb + 16 * pq) * 512 + h * 128 + pk;
#pragma unroll
          for (int i = 0; i < 16; ++i) qv[i] = bf2f(qp[(size_t)i * 512]); }
        v4u vst[2];
#pragma unroll
        for (int i = 0; i < 2; ++i) { const int c = tid + 512 * i, tok = c >> 4, part = c & 15; vst[i] = *(const GAS v4u*)(AV + (tokb + tok) * 512 + h * 128 + part * 8); }
        { float a = 0.f;
#pragma unroll
          for (int i = 0; i < 16; ++i) { a += lf[i]; cs[i] = a; } }
        LAS float* qsum = (LAS float*)(lds + HG_QSUM);
        qsum[pq * 128 + pk] = cs[15];
        HG_BAR();
        float off = 0.f, total = 0.f;
#pragma unroll
        for (int j = 0; j < 4; ++j) { const float t = qsum[j * 128 + pk]; total += t; if (j < pq) off += t; }
        if (MODE == 0 && pq == 0) seglog += total;
        if (pq == 0) ((LAS float*)(lds + HG_DEC))[pk] = __builtin_amdgcn_exp2f(total * LOG2E);
        { unsigned wq[8], wi[8], wsx[8];
#pragma unroll
          for (int i = 0; i < 16; i += 2) {
              float o2[2][3];
#pragma unroll
              for (int e = 0; e < 2; ++e) { const float bb = off + cs[i + e]; const float key = 1.0f - __builtin_amdgcn_exp2f(lf[i + e] * LOG2E);
                  o2[e][0] = (MODE == 1) ? qv[i + e] * __builtin_amdgcn_exp2f(bb * LOG2E) : 0.f;
                  o2[e][1] = (MODE == 1) ? key * __builtin_amdgcn_exp2f(-bb * LOG2E) : 0.f;
                  o2[e][2] = key * __builtin_amdgcn_exp2f((total - bb) * LOG2E); }
              wq[i >> 1] = cvtpk(o2[0][0], o2[1][0]); wi[i >> 1] = cvtpk(o2[0][1], o2[1][1]); wsx[i >> 1] = cvtpk(o2[0][2], o2[1][2]); }
          const int o_ = pk * HG_PT + 32 * pq;
          if (MODE == 1) { *(LAS v4u*)(lds + HG_QD + o_) = (v4u){wq[0], wq[1], wq[2], wq[3]}; *(LAS v4u*)(lds + HG_QD + o_ + 16) = (v4u){wq[4], wq[5], wq[6], wq[7]};
                           *(LAS v4u*)(lds + HG_KI + o_) = (v4u){wi[0], wi[1], wi[2], wi[3]}; *(LAS v4u*)(lds + HG_KI + o_ + 16) = (v4u){wi[4], wi[5], wi[6], wi[7]}; }
          *(LAS v4u*)(lds + HG_KS + o_) = (v4u){wsx[0], wsx[1], wsx[2], wsx[3]}; *(LAS v4u*)(lds + HG_KS + o_ + 16) = (v4u){wsx[4], wsx[5], wsx[6], wsx[7]}; }
#pragma unroll
        for (int i = 0; i < 2; ++i) { const int c = tid + 512 * i, tok = c >> 4, part = c & 15; *(LAS v4u*)(lds + HG_VV + tok * HG_PV + part * 16) = vst[i]; }
        HG_BAR();
        bf16x8 vfr[2];
#pragma unroll
        for (int ks2 = 0; ks2 < 2; ++ks2) { const LAS unsigned char* vp = lds + HG_VV + (32 * ks2 + 8 * fq + q_) * HG_PV + 32 * w + 8 * p_;
            const s16x4 lo = vtr(vp), hh = vtr(vp + 4 * HG_PV); vfr[ks2] = (bf16x8){lo[0], lo[1], lo[2], lo[3], hh[0], hh[1], hh[2], hh[3]}; }
        if (MODE == 1) {
            { const int cb = w & 3;
              bf16x8 qfrag[4];
#pragma unroll
              for (int ks = 0; ks < 4; ++ks) { const LAS unsigned char* qp = lds + HG_QD + (32 * ks + 8 * fq + q_) * HG_PT + 32 * cb + 8 * p_;
                  const s16x4 lo = vtr(qp), hh = vtr(qp + 4 * HG_PT); qfrag[ks] = (bf16x8){lo[0], lo[1], lo[2], lo[3], hh[0], hh[1], hh[2], hh[3]}; }
#pragma unroll
              for (int sj = 0; sj < 2; ++sj) { const int sb = 2 * (w >> 2) + sj; f32x4 d = {0.f, 0.f, 0.f, 0.f};
#pragma unroll
                  for (int ks = 0; ks < 4; ++ks) { const LAS unsigned char* kp = lds + HG_KI + (32 * ks + 8 * fq + q_) * HG_PT + 32 * sb + 8 * p_;
                      const s16x4 lo = vtr(kp), hh = vtr(kp + 4 * HG_PT); const bf16x8 kfrag = (bf16x8){lo[0], lo[1], lo[2], lo[3], hh[0], hh[1], hh[2], hh[3]};
                      d = MFMA16(kfrag, qfrag[ks], d); }
                  const int c = 16 * cb + fr, s0 = 16 * sb + 4 * fq;
#pragma unroll
                  for (int r = 0; r < 4; ++r) d[r] = (s0 + r <= c) ? d[r] : 0.f;
                  typedef unsigned u32x2 __attribute__((ext_vector_type(2)));
                  *(LAS u32x2*)(lds + HG_AA + c * HG_PT + s0 * 2) = (u32x2){cvtpk(d[0], d[1]), cvtpk(d[2], d[3])}; } }
            HG_BAR();
            f32x4 oc[4];
#pragma unroll
            for (int cb = 0; cb < 4; ++cb) { oc[cb] = (f32x4){0.f, 0.f, 0.f, 0.f};
#pragma unroll
                for (int ks2 = 0; ks2 < 2; ++ks2) if (ks2 <= (cb >> 1)) {
                    const bf16x8 af = *(const LAS bf16x8*)(lds + HG_AA + (16 * cb + fr) * HG_PT + (32 * ks2 + 8 * fq) * 2);
                    oc[cb] = MFMA16(af, vfr[ks2], oc[cb]); } }
#pragma unroll
            for (int ks = 0; ks < 4; ++ks) {
                v4u sw; sw.x = cvtpk(st[2 * ks][0], st[2 * ks][1]); sw.y = cvtpk(st[2 * ks][2], st[2 * ks][3]); sw.z = cvtpk(st[2 * ks + 1][0], st[2 * ks + 1][1]); sw.w = cvtpk(st[2 * ks + 1][2], st[2 * ks + 1][3]);
                const bf16x8 sfrag = __builtin_bit_cast(bf16x8, sw);
#pragma unroll
                for (int cb = 0; cb < 4; ++cb) { const LAS unsigned char* qp = lds + HG_QD + (32 * ks + 4 * fq + q_) * HG_PT + 32 * cb + 8 * p_;
                    const s16x4 lo = vtr(qp), hh = vtr(qp + 16 * HG_PT); const bf16x8 qa = (bf16x8){lo[0], lo[1], lo[2], lo[3], hh[0], hh[1], hh[2], hh[3]};
                    oc[cb] = MFMA16(qa, sfrag, oc[cb]); } }
            LAS float* ssq = (LAS float*)(lds + HG_SSQ);
#pragma unroll
            for (int cb = 0; cb < 4; ++cb)
#pragma unroll
                for (int r = 0; r < 4; ++r) { float q = oc[cb][r] * oc[cb][r]; q += __shfl_xor(q, 1); q += __shfl_xor(q, 2); q += __shfl_xor(q, 4); q += __shfl_xor(q, 8);
                    const int c = 16 * cb + 4 * fq + r; if (fr == 0) ssq[c * 8 + w] = q;
                    *(LAS float*)(lds + HG_OUT + c * HG_PO + (16 * w + fr) * 4) = oc[cb][r]; }
            HG_BAR();
            { const int tok = tid >> 3, part = tid & 7;
              const f32x4 s0 = *(const LAS f32x4*)(ssq + tok * 8), s1 = *(const LAS f32x4*)(ssq + tok * 8 + 4);
              const float rs = __builtin_amdgcn_rsqf(((s0[0] + s0[1]) + (s0[2] + s0[3]) + (s1[0] + s1[1]) + (s1[2] + s1[3])) * (1.0f / 128.0f) + EPS);
              const v4u gq[2] = {*(const GAS v4u*)(AG + (tokb + tok) * 512 + h * 128 + 16 * part), *(const GAS v4u*)(AG + (tokb + tok) * 512 + h * 128 + 16 * part + 8)};
              v4u ow[2];
#pragma unroll
              for (int hf = 0; hf < 2; ++hf) { float y[8];
#pragma unroll
                  for (int q4 = 0; q4 < 2; ++q4) { const f32x4 ov = *(const LAS f32x4*)(lds + HG_OUT + tok * HG_PO + (16 * part + 8 * hf + 4 * q4) * 4);
                      const f32x4 ng = *(const GAS f32x4*)(F.hgrn_norm_g + h * 128 + 16 * part + 8 * hf + 4 * q4);
#pragma unroll
                      for (int e = 0; e < 4; ++e) { const unsigned gw = gq[hf][q4 * 2 + (e >> 1)]; const float gt = __uint_as_float((e & 1) ? (gw & 0xffff0000u) : (gw << 16));
                          y[4 * q4 + e] = ov[e] * rs * ng[e] * gt; } }
                  ow[hf] = (v4u){cvtpk(y[0], y[1]), cvtpk(y[2], y[3]), cvtpk(y[4], y[5]), cvtpk(y[6], y[7])}; }
              *(GAS v4u*)(MIX + (tokb + tok) * 1024 + h * 128 + 16 * part) = ow[0]; *(GAS v4u*)(MIX + (tokb + tok) * 1024 + h * 128 + 16 * part + 8) = ow[1]; }
        }
        if (MODE == 0 || ch + 1 < SEGCH) {
#pragma unroll
            for (int kt = 0; kt < 8; ++kt) { const f32x4 dc = *(const LAS f32x4*)(lds + HG_DEC + (16 * kt + 4 * fq) * 4); st[kt] = st[kt] * dc;
#pragma unroll
                for (int ks2 = 0; ks2 < 2; ++ks2) { const bf16x8 af = *(const LAS bf16x8*)(lds + HG_KS + (16 * kt + fr) * HG_PT + (32 * ks2 + 8 * fq) * 2);
                    st[kt] = MFMA16(af, vfr[ks2], st[kt]); } }
        }
    }
    if (MODE == 0) {
#pragma unroll
        for (int kt = 0; kt < 8; ++kt)
#pragma unroll
            for (int r = 0; r < 4; ++r) SLOC[frag_base + (kt * 4 + r) * 64] = st[kt][r];
        if (pq == 0) DSEG[(size_t)(bh * NSEG + g) * 128 + pk] = __builtin_amdgcn_exp2f(seglog * LOG2E);
    }
    HG_BAR();
}
__device__ __forceinline__ void hgrn_scan(Frame& F) {
    const float* SLOC = (const float*)(F.ws + WS_SLOC); float* SIN = (float*)(F.ws + WS_SIN); const float* DSEG = (const float*)(F.ws + WS_DSEG);
    for (int e = F.vcu * 512 + F.tid; e < 8 * 16384; e += F.G * 512) {
        const int bh = e >> 14, pos = e & 16383, reg = (pos >> 6) & 31, ln = pos & 63, k = 16 * (reg >> 2) + 4 * (ln >> 4) + (reg & 3);
        float sl[NSEG], dg[NSEG];
#pragma unroll
        for (int g = 0; g < NSEG; ++g) { sl[g] = SLOC[(size_t)(bh * NSEG + g) * 16384 + pos]; dg[g] = DSEG[(size_t)(bh * NSEG + g) * 128 + k]; }
        float S = 0.f;
#pragma unroll
        for (int g = 0; g < NSEG; ++g) { SIN[(size_t)(bh * NSEG + g) * 16384 + pos] = S; S = dg[g] * S + sl[g]; }
    }
}
__device__ __forceinline__ void hgrn_pass1_phase(Frame& F) { for (int u = F.vcu; u < 8 * NSEG; u += F.G) hgrn_unit<0>(F, u / NSEG, u % NSEG); }
__device__ __forceinline__ void hgrn_pass3_phase(Frame& F) { for (int u = F.vcu; u < 8 * NSEG; u += F.G) hgrn_unit<1>(F, u / NSEG, u % NSEG); }
}
#define MIXER_PHASES \
    if (IN(2)) { mx::hgrn_pass1_phase(F); mx::swa_phase(F); if (BOTH(2)) GRID_BAR(); } \
    if (IN(3)) { mx::hgrn_scan(F); if (BOTH(3)) GRID_BAR(); } \
    if (IN(4)) { mx::hgrn_pass3_phase(F); if (BOTH(4)) GRID_BAR(); }
struct Args { const float* in[13]; float* out; unsigned char* ws; int ph_lo, ph_hi, li, pad; };
constexpr int NPHASE = 9;
__global__ void __launch_bounds__(NWAVES * 64, 2) mk_fwd(Args args) {
    extern __shared__ __attribute__((aligned(16))) unsigned char lds[];
    Frame F;
    F.lds = (LAS unsigned char*)lds;
    F.MISC = (volatile LAS unsigned*)(F.lds + MISC_OFF);
    F.tid = threadIdx.x; F.lane = F.tid & 63; F.wave = __builtin_amdgcn_readfirstlane(F.tid >> 6);
    F.G = gridDim.x; { const int bx = blockIdx.x; F.vcu = (F.G % 8 == 0) ? (bx % 8) * (F.G / 8) + bx / 8 : bx; }
    F.ws = args.ws; F.ctl = (gu32*)(args.ws + WS_CTL); F.out = args.out;
    F.x = args.in[0]; F.ln1_g = args.in[1]; F.w_in = args.in[2]; F.lb_logits = args.in[3]; F.hgrn_norm_g = args.in[4]; F.attn_sinks = args.in[5]; F.attn_norm_g = args.in[6];
    F.w_out = args.in[7]; F.ln2_g = args.in[8]; F.w_gate = args.in[9]; F.w_up = args.in[10]; F.w_down = args.in[11]; F.final_g = args.in[12];
    for (int u = F.tid; u < (LDS_BYTES - LDSCTL_OFF) / 4; u += NWAVES * 64) ((LAS unsigned*)(F.lds + LDSCTL_OFF))[u] = 0u;
    __syncthreads();
    XcdBarrier bar = xcd_barrier_post((unsigned*)(F.ctl + CW_BAR) + args.li * XCD_BAR_WORDS, F.MISC + 8);
    const int lo = args.ph_lo, hi = args.ph_hi;
#define IN(k) (lo <= (k) && (k) < hi)
#define BOTH(k) (IN(k) && IN((k) + 1))
#define GRID_BAR() xcd_barrier(bar)
    bf16* XN = (bf16*)(F.ws + WS_XN); bf16* MIX = (bf16*)(F.ws + WS_MIX); bf16* ACT = (bf16*)(F.ws + WS_ACT);
    float* SS2 = (float*)(F.ws + WS_SS2); float* SS3 = (float*)(F.ws + WS_SS3);

    if (IN(0)) { p0_prologue(F); if (BOTH(0)) GRID_BAR(); }
    if (IN(1)) {
        pg8::Gemm g{XN, (const bf16*)(F.ws + WS_WIN), M, INC, DM}; pg8::StaticOrder S; S.init(M, INC, F.G, (int)blockIdx.x);
        pg8::EpiInProj E{(bf16*)(F.ws + WS_AQ), (bf16*)(F.ws + WS_AV), (bf16*)(F.ws + WS_AG), (bf16*)(F.ws + WS_BQ), (bf16*)(F.ws + WS_BK), (bf16*)(F.ws + WS_BV), (float*)(F.ws + WS_ALOGF), (const float*)(F.ws + WS_LB), QSCALE};
        pg8::gemm_phase<pg8::EpiInProj, pg8::StaticOrder, PG8_ALIGN, PG8_SP2>(F.lds + RING_OFF, g, S, E);
        if (BOTH(1)) GRID_BAR();
    }
    MIXER_PHASES
    if (IN(5)) {
        pg8::Gemm g{MIX, (const bf16*)(F.ws + WS_WO), M, DM, DM}; pg8::StaticOrder S; S.init(M, DM, F.G, (int)blockIdx.x);
        pg8::EpiOutProj E{F.x, F.out, XN, SS2};
        pg8::gemm_phase<pg8::EpiOutProj, pg8::StaticOrder, false, PG8_SP2>(F.lds + RING_OFF, g, S, E);
        if (BOTH(5)) GRID_BAR();
    }
    if (IN(6)) {
        pg8::Gemm g{XN, (const bf16*)(F.ws + WS_WGU), M, 2 * DFF, DM}; pg8::StaticOrder S; S.init(M, 2 * DFF, F.G, (int)blockIdx.x);
        pg8::EpiGateUp E{ACT, SS2, EPS};
        pg8::gemm_phase<pg8::EpiGateUp, pg8::StaticOrder, PG8_ALIGN, PG8_SP2>(F.lds + RING_OFF, g, S, E);
        if (BOTH(6)) GRID_BAR();
    }
    if (IN(7)) {
        pg8::Gemm g{ACT, (const bf16*)(F.ws + WS_WD), M, DM, DFF}; pg8::StaticOrder S; S.init(M, DM, F.G, (int)blockIdx.x);
        pg8::EpiDown E{F.out, SS3};
        pg8::gemm_phase<pg8::EpiDown, pg8::StaticOrder, false, PG8_SP2>(F.lds + RING_OFF, g, S, E);
        if (BOTH(7)) GRID_BAR();
    }
    if (IN(8)) final_norm(F);
#undef IN
#undef BOTH
}
static int g_grid = 0;
static bool mk_setup() {
    if (g_grid != 0) return g_grid > 0;
    int dev = 0, cus = 0, per_cu = 0;
    if (hipGetDevice(&dev) != hipSuccess || hipDeviceGetAttribute(&cus, hipDeviceAttributeMultiprocessorCount, dev) != hipSuccess) { fprintf(stderr, "kernel_launch: device query failed\n"); g_grid = -1; return false; }
    if (hipFuncSetAttribute((const void*)mk_fwd, hipFuncAttributeMaxDynamicSharedMemorySize, LDS_BYTES) != hipSuccess) { fprintf(stderr, "kernel_launch: hipFuncSetAttribute failed\n"); g_grid = -1; return false; }
    if (hipOccupancyMaxActiveBlocksPerMultiprocessor(&per_cu, (const void*)mk_fwd, NWAVES * 64, LDS_BYTES) != hipSuccess || per_cu < 1) { fprintf(stderr, "kernel_launch: occupancy query says %d blocks/CU\n", per_cu); (void)hipGetLastError(); g_grid = -1; return false; }
    g_grid = cus;
    if (g_grid != 256) fprintf(stderr, "kernel_launch: %d CUs; this kernel is laid out for 256\n", g_grid);
    return true;
}
static void mk_launch(const Args& a0, int lo, int hi, int li, hipStream_t stream) {
    Args a = a0; a.ph_lo = lo; a.ph_hi = hi; a.li = li;
    void* params[] = {(void*)&a};
    hipError_t e = hipLaunchCooperativeKernel((const void*)mk_fwd, dim3(g_grid), dim3(NWAVES * 64), params, LDS_BYTES, stream);
    if (e != hipSuccess) fprintf(stderr, "kernel_launch: cooperative launch failed: %s\n", hipGetErrorString(e));
}
extern "C" void kernel_launch(void* const* d_in, const int* in_sizes, int n_in, void* d_out, int out_size, void* d_ws, size_t ws_size, hipStream_t stream) {
    if (!mk_setup()) return;
    if (n_in != 13 || ws_size < (HYBRID >= 4 ? 244 * MiB : WS_END)) { fprintf(stderr, "kernel_launch: unexpected inputs (n_in %d, ws %zu)\n", n_in, ws_size); return; }
    (void)hipMemsetAsync((char*)d_ws + WS_CTL, 0, CTL_ZERO_BYTES, stream);
    Args a{};
    for (int i = 0; i < 13; ++i) a.in[i] = (const float*)d_in[i];
    a.out = (float*)d_out; a.ws = (unsigned char*)d_ws;
    unsigned char* ws = (unsigned char*)d_ws;
#if HYBRID
    mk_launch(a, 0, 2, 0, stream);
    float* tmp = (float*)(ws + WS_XN);
    bf16* MIXP = (bf16*)(ws + WS_MIX); bf16* CMP = (bf16*)(ws + 228 * MiB);
#if HYBRID == 1 || HYBRID == 2
    hipLaunchKernelGGL(dev::hgrn_naive, dim3(BATCH * AH), dim3(128), 0, stream, (const bf16*)(ws + WS_AQ), (const float*)(ws + WS_ALOGF), (const bf16*)(ws + WS_AV), tmp);
    hipLaunchKernelGGL(dev::hgrn_post, dim3(M * AH / 4), dim3(256), 0, stream, (const float*)tmp, (const bf16*)(ws + WS_AG), (const float*)d_in[4], MIXP, 1024);
#endif
#if HYBRID == 1 || HYBRID == 3
    hipLaunchKernelGGL(dev::swa_naive, dim3(M * BHEADS / 64), dim3(64), 0, stream, (const bf16*)(ws + WS_BQ), (const bf16*)(ws + WS_BK), (const bf16*)(ws + WS_BV), (const float*)d_in[5], tmp);
    hipLaunchKernelGGL(dev::attn_norm, dim3(M / 4), dim3(256), 0, stream, (const float*)tmp, (const float*)d_in[6], MIXP + 512, 1024);
#endif
#if HYBRID == 4
    hipLaunchKernelGGL(dev::swa_naive, dim3(M * BHEADS / 64), dim3(64), 0, stream, (const bf16*)(ws + WS_BQ), (const bf16*)(ws + WS_BK), (const bf16*)(ws + WS_BV), (const float*)d_in[5], tmp);
    hipLaunchKernelGGL(dev::attn_norm, dim3(M / 4), dim3(256), 0, stream, (const float*)tmp, (const float*)d_in[6], CMP, 512);
#endif
#if HYBRID == 5
    hipLaunchKernelGGL(dev::hgrn_naive, dim3(BATCH * AH), dim3(128), 0, stream, (const bf16*)(ws + WS_AQ), (const float*)(ws + WS_ALOGF), (const bf16*)(ws + WS_AV), tmp);
    hipLaunchKernelGGL(dev::hgrn_post, dim3(M * AH / 4), dim3(256), 0, stream, (const float*)tmp, (const bf16*)(ws + WS_AG), (const float*)d_in[4], CMP, 512);
#endif
#if HYBRID == 2
    mk_launch(a, 2, 3, 2, stream);
#endif
#if HYBRID >= 3
    mk_launch(a, 2, 5, 2, stream);
#endif
    mk_launch(a, 5, 9, 1, stream);
#if HYBRID == 4 || HYBRID == 5
    float* sums = (float*)(ws + WS_CTL) + 60000;
    hipLaunchKernelGGL(dev::diag_cmp, dim3(1024), dim3(256), 0, stream, (const bf16*)(MIXP + (HYBRID == 4 ? 512 : 0)), 1024, (const bf16*)CMP, 512, sums);
    hipLaunchKernelGGL(dev::diag_write, dim3(1), dim3(64), 0, stream, (const float*)sums, (float*)d_out);
#endif
#else
    mk_launch(a, 0, NPHASE, 0, stream);
#endif
}
```
